# Optimizing an MI355X kernel written in HIP

```python
import jax, jax.numpy as jnp
from jax import lax
import numpy as np

D_MODEL = 1024
BATCH = 8
SEQ = 4096
DEPTH = 1

CHUNK = 64
N_MEM = 256
D_MIX = D_MODEL
D_CONV = 3 * D_MIX // 8
D_POOL = 3 * D_MIX // 8
D_ATT = D_MIX - D_CONV - D_POOL
N_MEM_HEADS = 4
HEAD_DIM = D_ATT // N_MEM_HEADS
CONV_WIDTH = 3
POOL_WINDOWS = (2, 4, 8, 16)
N_POOL_GROUPS = len(POOL_WINDOWS)
POOL_GROUP = D_POOL // N_POOL_GROUPS
D_IN_PROJ = 4 * D_CONV + 2 * D_POOL + 2 * D_ATT
EPS = 1e-6

kernel_name = "hybrid_conv_pool_memattn_block"


def rmsnorm(x, w):
    xf = x.astype(jnp.float32)
    y = xf * lax.rsqrt(jnp.mean(xf * xf, axis=-1, keepdims=True) + EPS)
    return (y * w.astype(jnp.float32)).astype(x.dtype)


def short_conv_causal(u, w):
    s = u.shape[1]
    up = jnp.pad(u, ((0, 0), (CONV_WIDTH - 1, 0), (0, 0)))
    y = up[:, 0:s] * w[0]
    for k in range(1, CONV_WIDTH):
        y = y + up[:, k:k + s] * w[k]
    return y


def multiscale_pool(u, pool_w, pool_scale):
    b, s, _ = u.shape
    ug = u.reshape(b, s, N_POOL_GROUPS, POOL_GROUP)
    ugf = ug.astype(jnp.float32)
    cs = jnp.cumsum(ugf, axis=1)
    t = jnp.arange(s)
    outs = []
    for g, win in enumerate(POOL_WINDOWS):
        c = cs[:, :, g]
        shifted = jnp.pad(c, ((0, 0), (win, 0), (0, 0)))[:, :s]
        cnt = jnp.minimum(t + 1, win).astype(jnp.float32)[:, None]
        outs.append((c - shifted) / cnt)
    pooled = jnp.stack(outs, axis=2)
    diff = (pooled - ugf).astype(u.dtype)
    mixed = jnp.einsum('bsgc,gcd->bsgd', diff, pool_w)
    return mixed.reshape(b, s, D_POOL) * pool_scale


def memory_attention(q, mem_n, w_kv):
    b, s, _ = q.shape
    m = mem_n.shape[1]
    kv = mem_n @ w_kv
    k, v = jnp.split(kv, 2, axis=-1)
    qh = q.reshape(b, s, N_MEM_HEADS, HEAD_DIM)
    kh = k.reshape(b, m, N_MEM_HEADS, HEAD_DIM)
    vh = v.reshape(b, m, N_MEM_HEADS, HEAD_DIM)
    scores = jnp.einsum('bshd,bmhd->bhsm', qh, kh).astype(jnp.float32) * (HEAD_DIM ** -0.5)
    probs = jax.nn.softmax(scores, axis=-1).astype(q.dtype)
    out = jnp.einsum('bhsm,bmhd->bshd', probs, vh)
    return out.reshape(b, s, D_ATT)


def hybrid_layer(x, mem, pre_w, mem_norm_w, w_in, conv_w, pool_w, pool_scale, w_kv, w_out, post_w):
    h = rmsnorm(x, pre_w)
    proj = h @ w_in
    splits = np.cumsum([D_CONV, D_CONV, D_CONV, D_CONV, D_POOL, D_POOL, D_ATT]).tolist()
    xc, bg, cg, gc, xp, gp, q, ga = jnp.split(proj, splits, axis=-1)
    y_conv = bg * short_conv_causal(cg * xc, conv_w)
    y_pool = multiscale_pool(xp, pool_w, pool_scale)
    y_att = memory_attention(q, rmsnorm(mem, mem_norm_w), w_kv)
    y = jnp.concatenate([y_conv * jax.nn.silu(gc),
                         y_pool * jax.nn.silu(gp),
                         y_att * jax.nn.silu(ga)], axis=-1) @ w_out
    return x + rmsnorm(y, post_w)


def setup_inputs(seed: int = 0) -> dict:
    key = jax.random.key(seed)
    ks = jax.random.split(key, 12)
    f32 = jnp.float32
    x = jax.random.normal(ks[0], (BATCH, SEQ, D_MODEL), f32)
    mem = jax.random.normal(ks[1], (BATCH, N_MEM, D_MODEL), f32)
    pre_norm_w = 1.0 + 0.02 * jax.random.normal(ks[2], (DEPTH, D_MODEL), f32)
    mem_norm_w = 1.0 + 0.02 * jax.random.normal(ks[3], (DEPTH, D_MODEL), f32)
    w_in = jax.random.normal(ks[4], (DEPTH, D_MODEL, D_IN_PROJ), f32) * D_MODEL ** -0.5
    conv_w = jax.random.normal(ks[5], (DEPTH, CONV_WIDTH, D_CONV), f32) * CONV_WIDTH ** -0.5
    pool_w = jax.random.normal(ks[6], (DEPTH, N_POOL_GROUPS, POOL_GROUP, POOL_GROUP), f32) * POOL_GROUP ** -0.5
    pool_scale = 1.0 + 0.02 * jax.random.normal(ks[7], (DEPTH, D_POOL), f32)
    w_kv = jax.random.normal(ks[8], (DEPTH, D_MODEL, 2 * D_ATT), f32) * D_MODEL ** -0.5
    w_out = jax.random.normal(ks[9], (DEPTH, D_MIX, D_MODEL), f32) * D_MIX ** -0.5
    post_norm_w = 1.0 + 0.02 * jax.random.normal(ks[10], (DEPTH, D_MODEL), f32)
    return {"x": x, "mem": mem, "pre_norm_w": pre_norm_w, "mem_norm_w": mem_norm_w,
            "w_in": w_in, "conv_w": conv_w, "pool_w": pool_w, "pool_scale": pool_scale,
            "w_kv": w_kv, "w_out": w_out, "post_norm_w": post_norm_w}


def reference(x, mem, pre_norm_w, mem_norm_w, w_in, conv_w, pool_w, pool_scale, w_kv, w_out, post_norm_w):
    for l in range(DEPTH):
        x = hybrid_layer(x, mem, pre_norm_w[l], mem_norm_w[l], w_in[l], conv_w[l], pool_w[l],
                         pool_scale[l], w_kv[l], w_out[l], post_norm_w[l])
    return x
```

```cpp
#include <hip/hip_runtime.h>
#include <hip/hip_cooperative_groups.h>
#include <cstdio>
#include <cstdint>
namespace cg = cooperative_groups;

#ifndef MK_N_LAUNCHES
#define MK_N_LAUNCHES 1
#endif

#define LAS __attribute__((address_space(3)))
typedef unsigned short bf16_t;
typedef short bf16x8 __attribute__((ext_vector_type(8)));
typedef float f32x4 __attribute__((ext_vector_type(4)));
typedef float f32x2 __attribute__((ext_vector_type(2)));
typedef unsigned u32x4 __attribute__((ext_vector_type(4)));
typedef unsigned u32x2 __attribute__((ext_vector_type(2)));
typedef __bf16 bf16x2_t __attribute__((ext_vector_type(2)));

constexpr int D = 1024, NB = 8, SEQ = 4096, NTOK = NB * SEQ, NMEM = 256, MEMROWS = NB * NMEM;
constexpr int DC = 384, DP = 384, DA = 256, NH = 4, HD = 64, PG = 96, NPROJ = 2816;
constexpr int OFF_XC = 0, OFF_BG = 384, OFF_CG = 768, OFF_GC = 1152, OFF_XP = 1536, OFF_GP = 1920, OFF_Q = 2304, OFF_GA = 2560;
constexpr float EPS = 1e-6f;

constexpr size_t MiB = 1u << 20;
constexpr size_t WS_WCAT = 1 * MiB;
constexpr size_t WS_WOUT = 8 * MiB;
constexpr size_t WS_PW = 10 * MiB;
constexpr size_t WS_KV = 11 * MiB;
constexpr size_t WS_ACAT = 16 * MiB;
constexpr size_t WS_MIX = 88 * MiB;
constexpr size_t WS_P = 152 * MiB;
constexpr size_t WS_END = 328 * MiB;

constexpr int NWAVES = 8, NTHREADS = 512;
constexpr int LDS_BYTES = 135168;

__device__ __forceinline__ unsigned pk(float a, float b) { bf16x2_t v = {(__bf16)a, (__bf16)b}; return __builtin_bit_cast(unsigned, v); }
__device__ __forceinline__ float silu(float v) { return v / (1.0f + __expf(-v)); }
__device__ __forceinline__ float bflo(unsigned w) { return __uint_as_float(w << 16); }
__device__ __forceinline__ float bfhi(unsigned w) { return __uint_as_float(w & 0xffff0000u); }
__device__ __forceinline__ void unpack8(const u32x4 v, float (&f)[8]) { f[0] = bflo(v.x); f[1] = bfhi(v.x); f[2] = bflo(v.y); f[3] = bfhi(v.y); f[4] = bflo(v.z); f[5] = bfhi(v.z); f[6] = bflo(v.w); f[7] = bfhi(v.w); }
__device__ __forceinline__ float wave_sum(float v) {
#pragma unroll
    for (int o = 1; o < 64; o <<= 1) v += __shfl_xor(v, o);
    return v;
}

namespace pg8 {
constexpr int BM = 256, BK = 64, HALF = 128, HTB = HALF * BK * 2, STAGE_BYTES = 8 * HTB, NXCD = 8, WGM = 8;
__host__ __device__ __forceinline__ int lds_byte(int r, int c) { const int st = (r >> 4) * 2 + (c >> 5), rr = r & 15, cc = c & 31, ob = rr * 64 + cc * 2; return st * 1024 + (ob ^ (((ob >> 9) & 1) << 5)); }
__host__ __device__ __forceinline__ void stage_rc(int b, int& R, int& C) { const int st = b / 1024, sb = b % 1024, swz = sb ^ (((sb >> 9) & 1) << 5); R = (st >> 1) * 16 + swz / 64; C = (st & 1) * 32 + (swz % 64) / 2; }
__host__ __device__ __forceinline__ int perm32(int rho) { const int n = rho >> 4, i = rho & 15; return 8 * (i >> 2) + 4 * n + (i & 3); }
struct Unit { int pm, pn; };
struct Gemm { const bf16_t* A; const bf16_t* Bt; int M, N, K; };
struct StaticOrder {
    int nM, nN, nwg, G, c;
    __host__ __device__ void init(int M, int N, int G_, int c_) { nM = M / BM; nN = N / BM; nwg = nM * nN; G = G_; c = c_; }
    __host__ __device__ bool next(int i, Unit& u) const {
        const long L = (long)i * G + c; if (L >= nwg) return false;
        int wgid = (int)L; { const int q = nwg / NXCD, r = nwg % NXCD, xcd = wgid % NXCD, off = wgid / NXCD; wgid = (xcd < r ? xcd * (q + 1) : r * (q + 1) + (xcd - r) * q) + off; }
        const int nig = WGM * nN, gid = wgid / nig, fm = gid * WGM, gsz = (nM - fm) < WGM ? (nM - fm) : WGM;
        u.pm = fm + ((wgid % nig) % gsz); u.pn = (wgid % nig) / gsz; return true;
    }
};
struct Order1 {
    StaticOrder so; int G, c;
    __device__ void init(int G_, int c_) { so.init(NTOK, NPROJ, G_, c_); G = G_; c = c_; }
    __device__ bool next(int i, Unit& u) const {
        const long L = (long)i * G + c;
        if (L < so.nwg) return so.next(i, u);
        if (L < so.nwg + 16) { const int j = (int)L - so.nwg; u.pm = 128 + (j & 7); u.pn = 11 + (j >> 3); return true; }
        return false;
    }
};
struct EpiP1 {
    static constexpr bool PERM = true;
    bf16_t* P; bf16_t* KV;
    __device__ __forceinline__ void operator()(const f32x4 (&acc)[2][2][4][2], const Unit& u, int wr, int wc, int fr, int fq) const {
        bf16_t* base; int ldc, rowt, colt;
        if (u.pm < 128) { base = P; ldc = NPROJ; rowt = u.pm * BM; colt = u.pn * BM; } else { base = KV; ldc = 512; rowt = (u.pm - 128) * BM; colt = (u.pn - 11) * BM; }
        const int row0 = rowt + wr * 64 + fr, col0 = colt + wc * 32 + 8 * fq;
#pragma unroll
        for (int ai = 0; ai < 2; ++ai)
#pragma unroll
            for (int m = 0; m < 4; ++m) { bf16_t* rowp = base + (size_t)(row0 + ai * HALF + m * 16) * ldc + col0;
#pragma unroll
                for (int bj = 0; bj < 2; ++bj) { const f32x4 v0 = acc[ai][bj][m][0], v1 = acc[ai][bj][m][1];
                    u32x4 w; w.x = pk(v0[0], v0[1]); w.y = pk(v0[2], v0[3]); w.z = pk(v1[0], v1[1]); w.w = pk(v1[2], v1[3]);
                    *(u32x4*)(rowp + bj * HALF) = w; } }
    }
};
struct EpiF32 {
    static constexpr bool PERM = false;
    float* C; int ldc;
    __device__ __forceinline__ void operator()(const f32x4 (&acc)[2][2][4][2], const Unit& u, int wr, int wc, int fr, int fq) const {
        const int row0 = u.pm * BM + wr * 64 + fr, col0 = u.pn * BM + wc * 32 + 4 * fq;
#pragma unroll
        for (int ai = 0; ai < 2; ++ai)
#pragma unroll
            for (int m = 0; m < 4; ++m) { float* rowp = C + (size_t)(row0 + ai * HALF + m * 16) * ldc + col0;
#pragma unroll
                for (int bj = 0; bj < 2; ++bj)
#pragma unroll
                    for (int n = 0; n < 2; ++n) *(f32x4*)(rowp + bj * HALF + n * 16) = acc[ai][bj][m][n]; }
    }
};

template <class Epi, class Sched, bool ALIGN_EPI = true>
__device__ __forceinline__ void gemm_phase(LAS unsigned char* lds, const Gemm g, const Sched& S, const Epi& E) {
    const int tid = threadIdx.x, wid = __builtin_amdgcn_readfirstlane(tid >> 6), lane = tid & 63, wr = wid >> 2, wc = wid & 3, fr = lane & 15, fq = lane >> 4;
    const int K = g.K, nt = K / BK;
    unsigned voffA[2], voffB[2];
#pragma unroll
    for (int i = 0; i < 2; ++i) { int R, C; stage_rc(tid * 16 + i * 8192, R, C); const int Rb = Epi::PERM ? ((R & ~31) + perm32(R & 31)) : R;
        voffA[i] = (unsigned)(R * K + C) * 2u; voffB[i] = (unsigned)(Rb * K + C) * 2u; }
    const size_t kstep = (size_t)(BK * 2);
    const size_t hstep = (size_t)HALF * K * 2;
    const size_t tstep = 2 * hstep;
    const unsigned ldsw = (unsigned)wid * 1024u;
    const int aoff = lds_byte(wr * 64 + fr, fq * 8), boff = lds_byte(wc * 32 + fr, fq * 8);
#define PG8_SA(b, h) (((b) * 2 + (h)) * HTB)
#define PG8_SB(b, h) ((4 + (b) * 2 + (h)) * HTB)
#define PG8_STAGE(bufoff, gbase, voff) do { _Pragma("unroll") for (int _i = 0; _i < 2; ++_i) \
        __builtin_amdgcn_global_load_lds((const unsigned*)((const char*)(gbase) + (voff)[_i]), (LAS unsigned*)(lds + (bufoff) + ldsw + _i * 8192), 16, 0, 0); } while (0)
#define PG8_LDA(dst, b, h) do { _Pragma("unroll") for (int m = 0; m < 4; ++m) _Pragma("unroll") for (int k = 0; k < 2; ++k) dst[m][k] = *(const LAS bf16x8*)(lds + PG8_SA(b, h) + aoff + m * 2048 + k * 1024); } while (0)
#define PG8_LDB(dst, b, h) do { _Pragma("unroll") for (int n = 0; n < 2; ++n) _Pragma("unroll") for (int k = 0; k < 2; ++k) dst[n][k] = *(const LAS bf16x8*)(lds + PG8_SB(b, h) + boff + n * 2048 + k * 1024); } while (0)
#define PG8_MMA(ai, bj, At, Bt) do { __builtin_amdgcn_s_setprio(1); _Pragma("unroll") for (int m = 0; m < 4; ++m) _Pragma("unroll") for (int n = 0; n < 2; ++n) _Pragma("unroll") for (int k = 0; k < 2; ++k) \
        acc[ai][bj][m][n] = __builtin_amdgcn_mfma_f32_16x16x32_bf16(Bt[n][k], At[m][k], acc[ai][bj][m][n], 0, 0, 0); __builtin_amdgcn_s_setprio(0); } while (0)
#define PG8_WAIT_V(n) asm volatile("s_waitcnt vmcnt(" #n ")" ::: "memory")
#define PG8_WAIT_L(n) asm volatile("s_waitcnt lgkmcnt(" #n ")" ::: "memory")
#define PG8_BAR __builtin_amdgcn_s_barrier()
#define PG8_SCHED __builtin_amdgcn_sched_barrier(0)
    Unit cur, nxt; int ui = 0;
    if (!S.next(0, cur)) return;
    f32x4 acc[2][2][4][2];
#pragma unroll
    for (int a = 0; a < 2; ++a)
#pragma unroll
        for (int b = 0; b < 2; ++b)
#pragma unroll
            for (int m = 0; m < 4; ++m)
#pragma unroll
                for (int n = 0; n < 2; ++n) acc[a][b][m][n] = (f32x4){0.f, 0.f, 0.f, 0.f};
    bf16x8 At[4][2], B0[2][2], B1[2][2];
    const char* cA = (const char*)g.A + (size_t)cur.pm * tstep; const char* cB = (const char*)g.Bt + (size_t)cur.pn * tstep;
    PG8_STAGE(PG8_SB(0, 0), cB, voffB); PG8_STAGE(PG8_SB(0, 1), cB + hstep, voffB); PG8_STAGE(PG8_SA(0, 0), cA, voffA); PG8_STAGE(PG8_SA(0, 1), cA + hstep, voffA);
    if (wr == 1) PG8_BAR;
    PG8_WAIT_V(2); PG8_BAR;
    PG8_STAGE(PG8_SB(1, 0), cB + kstep, voffB); PG8_STAGE(PG8_SA(1, 0), cA + kstep, voffA); PG8_STAGE(PG8_SB(1, 1), cB + hstep + kstep, voffB);
    PG8_WAIT_V(6); PG8_BAR;
    for (;;) {
        const bool has_next = S.next(ui + 1, nxt);
        const char* nA = has_next ? (const char*)g.A + (size_t)nxt.pm * tstep : cA; const char* nB = has_next ? (const char*)g.Bt + (size_t)nxt.pn * tstep : cB;
        for (int t = 0; t < nt; t += 2) {
            const bool last = (t == nt - 2);
            const char* a1 = cA + (size_t)(t + 1) * kstep;
            const char* a2 = last ? nA : cA + (size_t)(t + 2) * kstep; const char* b2 = last ? nB : cB + (size_t)(t + 2) * kstep;
            const char* a3 = a2 + kstep; const char* b3 = b2 + kstep;
            PG8_LDB(B0, 0, 0); PG8_LDB(B1, 0, 1); PG8_SCHED; PG8_LDA(At, 0, 0); PG8_STAGE(PG8_SA(1, 1), a1 + hstep, voffA);
            PG8_WAIT_V(8); PG8_WAIT_L(0); PG8_BAR; PG8_MMA(0, 0, At, B0); PG8_MMA(0, 1, At, B1); PG8_BAR; PG8_SCHED;
            PG8_LDA(At, 0, 1); PG8_STAGE(PG8_SB(0, 0), b2, voffB); PG8_STAGE(PG8_SB(0, 1), b2 + hstep, voffB); PG8_STAGE(PG8_SA(0, 0), a2, voffA);
            PG8_WAIT_V(8); PG8_WAIT_L(0); PG8_BAR; PG8_MMA(1, 0, At, B0); PG8_MMA(1, 1, At, B1); PG8_BAR; PG8_SCHED;
            PG8_LDB(B0, 1, 0); PG8_LDB(B1, 1, 1); PG8_SCHED; PG8_LDA(At, 1, 0); PG8_STAGE(PG8_SA(0, 1), a2 + hstep, voffA);
            PG8_WAIT_V(8); PG8_WAIT_L(0); PG8_BAR; PG8_MMA(0, 0, At, B0); PG8_MMA(0, 1, At, B1); PG8_BAR; PG8_SCHED;
            PG8_LDA(At, 1, 1); PG8_STAGE(PG8_SB(1, 0), b3, voffB); PG8_STAGE(PG8_SB(1, 1), b3 + hstep, voffB); PG8_STAGE(PG8_SA(1, 0), a3, voffA);
            PG8_WAIT_V(8); PG8_WAIT_L(0); PG8_BAR; PG8_MMA(1, 0, At, B0); PG8_MMA(1, 1, At, B1); PG8_BAR; PG8_SCHED;
        }
        if constexpr (ALIGN_EPI) { if (wr == 0) PG8_BAR; }
        E(acc, cur, wr, wc, fr, fq);
        if (!has_next) break;
#pragma unroll
        for (int a = 0; a < 2; ++a)
#pragma unroll
            for (int b = 0; b < 2; ++b)
#pragma unroll
                for (int m = 0; m < 4; ++m)
#pragma unroll
                    for (int n = 0; n < 2; ++n) acc[a][b][m][n] = (f32x4){0.f, 0.f, 0.f, 0.f};
        cur = nxt; cA = nA; cB = nB; ++ui;
        if constexpr (ALIGN_EPI) { if (wr == 1) PG8_BAR; }
    }
    PG8_WAIT_V(0);
    if constexpr (!ALIGN_EPI) { if (wr == 0) PG8_BAR; }
    PG8_BAR;
#undef PG8_SA
#undef PG8_SB
#undef PG8_STAGE
#undef PG8_LDA
#undef PG8_LDB
#undef PG8_MMA
#undef PG8_WAIT_V
#undef PG8_WAIT_L
#undef PG8_BAR
#undef PG8_SCHED
}
}

struct Args {
    const float *x, *mem, *pre_w, *mem_w, *w_in, *conv_w, *pool_w, *pool_scale, *w_kv, *w_out, *post_w;
    float* out; unsigned char* ws;
};

__device__ __forceinline__ void p0_transpose_item(const float* W, int K, int N, bf16_t* WT, int row_off, LAS float* scr, int item, int lane) {
    const int nblk = N / 32, kb = item / nblk, nb = item % nblk, k0 = 64 * kb, n0 = 32 * nb;
#pragma unroll 8
    for (int i = 0; i < 32; ++i) { const int kk = 2 * i + (lane >> 5); scr[kk * 33 + (lane & 31)] = W[(size_t)(k0 + kk) * N + n0 + (lane & 31)]; }
    asm volatile("s_waitcnt lgkmcnt(0)" ::: "memory");
    const int c = lane & 7;
#pragma unroll
    for (int j = 0; j < 4; ++j) { const int n = (lane >> 3) + 8 * j; const LAS float* s = scr + (8 * c) * 33 + n;
        u32x4 o; o.x = pk(s[0 * 33], s[1 * 33]); o.y = pk(s[2 * 33], s[3 * 33]); o.z = pk(s[4 * 33], s[5 * 33]); o.w = pk(s[6 * 33], s[7 * 33]);
        *(u32x4*)(WT + (size_t)(row_off + n0 + n) * K + k0 + 8 * c) = o; }
    asm volatile("s_waitcnt lgkmcnt(0)" ::: "memory");
}
__device__ __forceinline__ void rms_row_to_bf16(const float* xrow, const float* w, bf16_t* orow, int lane) {
    const f32x4* xr = (const f32x4*)xrow + lane; const f32x4* wr = (const f32x4*)w + lane;
    f32x4 v[4]; float s = 0.f;
#pragma unroll
    for (int j = 0; j < 4; ++j) { v[j] = xr[64 * j]; s += (v[j].x * v[j].x + v[j].y * v[j].y) + (v[j].z * v[j].z + v[j].w * v[j].w); }
    const float rstd = rsqrtf(wave_sum(s) * (1.f / D) + EPS);
    u32x2* o8 = (u32x2*)orow + lane;
#pragma unroll
    for (int j = 0; j < 4; ++j) { const f32x4 wv = wr[64 * j]; u32x2 o; o.x = pk(v[j].x * rstd * wv.x, v[j].y * rstd * wv.y); o.y = pk(v[j].z * rstd * wv.z, v[j].w * rstd * wv.w); o8[64 * j] = o; }
}
__device__ __forceinline__ void p0_prologue(const Args& a, LAS unsigned char* lds, int wave, int lane) {
    LAS float* scr = (LAS float*)(lds + wave * 16384);
    const int gw = blockIdx.x * NWAVES + wave, NGW = gridDim.x * NWAVES;
    bf16_t* WCAT = (bf16_t*)(a.ws + WS_WCAT); bf16_t* WOUT = (bf16_t*)(a.ws + WS_WOUT); bf16_t* PWT = (bf16_t*)(a.ws + WS_PW); bf16_t* ACAT = (bf16_t*)(a.ws + WS_ACAT);
    constexpr int I_IN = (D / 64) * (NPROJ / 32), I_KV = (D / 64) * (512 / 32), I_OUT = (D / 64) * (D / 32), NITEMS = I_IN + I_KV + I_OUT;
    for (int it = gw; it < NITEMS; it += NGW) {
        int r = it;
        if (r < I_IN) { p0_transpose_item(a.w_in, D, NPROJ, WCAT, 0, scr, r, lane); continue; } r -= I_IN;
        if (r < I_KV) { p0_transpose_item(a.w_kv, D, 512, WCAT, NPROJ, scr, r, lane); continue; } r -= I_KV;
        p0_transpose_item(a.w_out, D, D, WOUT, 0, scr, r, lane);
    }
    for (int i = (blockIdx.x * NTHREADS + threadIdx.x); i < 4 * PG * PG; i += gridDim.x * NTHREADS) {
        const int g = i / (PG * PG), r = i % (PG * PG), d = r / PG, c = r % PG;
        PWT[i] = (bf16_t)(pk(a.pool_w[(g * PG + c) * PG + d], 0.f) & 0xffffu);
    }
    for (int m = gw; m < NTOK + MEMROWS; m += NGW) {
        if (m < NTOK) rms_row_to_bf16(a.x + (size_t)m * D, a.pre_w, ACAT + (size_t)m * D, lane);
        else rms_row_to_bf16(a.mem + (size_t)(m - NTOK) * D, a.mem_w, ACAT + (size_t)m * D, lane);
    }
}

constexpr int DIFF_PITCH = 784;
constexpr int KS_PITCH = 144;
constexpr int VT_PITCH = 528;
constexpr int KS_OFF = 0, VT_OFF = 256 * KS_PITCH;

__device__ __forceinline__ void mix_conv(const Args& a, const bf16_t* P, bf16_t* MIX, int tile0, int tid) {
#pragma unroll 1
    for (int k = 0; k < 3; ++k) {
        const int item = tid + NTHREADS * k, seg = item / 48, cg8 = item % 48, t0 = tile0 + seg * 4, c0 = cg8 * 8;
        const bool halo = (t0 % SEQ) != 0;
        const bf16_t* base = P + (size_t)t0 * NPROJ + c0;
        u32x4 xcr[6], cgr[6], bgr[4], gcr[4];
#pragma unroll
        for (int j = 0; j < 6; ++j) {
            if (j >= 2 || halo) { const bf16_t* r = base + (ptrdiff_t)(j - 2) * NPROJ; xcr[j] = *(const u32x4*)(r + OFF_XC); cgr[j] = *(const u32x4*)(r + OFF_CG); }
            else { xcr[j] = (u32x4){0u, 0u, 0u, 0u}; cgr[j] = (u32x4){0u, 0u, 0u, 0u}; }
        }
#pragma unroll
        for (int j = 0; j < 4; ++j) { const bf16_t* r = base + (size_t)j * NPROJ; bgr[j] = *(const u32x4*)(r + OFF_BG); gcr[j] = *(const u32x4*)(r + OFF_GC); }
        float w0[8], w1[8], w2[8];
#pragma unroll
        for (int e = 0; e < 8; e += 4) { const f32x4 q0 = *(const f32x4*)(a.conv_w + c0 + e), q1 = *(const f32x4*)(a.conv_w + DC + c0 + e), q2 = *(const f32x4*)(a.conv_w + 2 * DC + c0 + e);
#pragma unroll
            for (int i = 0; i < 4; ++i) { w0[e + i] = q0[i]; w1[e + i] = q1[i]; w2[e + i] = q2[i]; } }
        float um2[8], um1[8];
        { float xa[8], ca[8]; unpack8(xcr[0], xa); unpack8(cgr[0], ca);
#pragma unroll
          for (int e = 0; e < 8; ++e) um2[e] = xa[e] * ca[e];
          unpack8(xcr[1], xa); unpack8(cgr[1], ca);
#pragma unroll
          for (int e = 0; e < 8; ++e) um1[e] = xa[e] * ca[e]; }
#pragma unroll
        for (int j = 0; j < 4; ++j) {
            float xa[8], ca[8], ba[8], ga[8], y[8]; unpack8(xcr[j + 2], xa); unpack8(cgr[j + 2], ca); unpack8(bgr[j], ba); unpack8(gcr[j], ga);
#pragma unroll
            for (int e = 0; e < 8; ++e) { const float u0 = xa[e] * ca[e]; y[e] = ba[e] * (w0[e] * um2[e] + w1[e] * um1[e] + w2[e] * u0) * silu(ga[e]); um2[e] = um1[e]; um1[e] = u0; }
            u32x4 o; o.x = pk(y[0], y[1]); o.y = pk(y[2], y[3]); o.z = pk(y[4], y[5]); o.w = pk(y[6], y[7]);
            *(u32x4*)(MIX + (size_t)(t0 + j) * D + c0) = o;
        }
    }
}

__device__ __forceinline__ void mix_pool(const Args& a, const bf16_t* P, const bf16_t* PWT, bf16_t* MIX, LAS unsigned char* lds, int tile0, int wave, int lane) {
    LAS unsigned char* dt = lds + wave * (16 * DIFF_PITCH);
    const int t0 = tile0 + wave * 16, s0 = t0 % SEQ;
    if (lane < 48) {
        const int c0 = lane * 8, g = lane / 12, win = 2 << g;
        const bf16_t* base = P + (size_t)t0 * NPROJ + OFF_XP + c0;
        float sum[8];
#pragma unroll
        for (int e = 0; e < 8; ++e) sum[e] = 0.f;
        if (s0 != 0) { for (int j = 1; j < win; ++j) { float xa[8]; unpack8(*(const u32x4*)(base - (ptrdiff_t)j * NPROJ), xa);
#pragma unroll
                for (int e = 0; e < 8; ++e) sum[e] += xa[e]; } }
#pragma unroll 4
        for (int i = 0; i < 16; ++i) {
            float xa[8], df[8]; unpack8(*(const u32x4*)(base + (size_t)i * NPROJ), xa);
            const int sp = s0 + i; const float cnt = (float)((sp + 1 < win) ? sp + 1 : win);
#pragma unroll
            for (int e = 0; e < 8; ++e) { sum[e] += xa[e]; df[e] = sum[e] / cnt - xa[e]; }
            u32x4 o; o.x = pk(df[0], df[1]); o.y = pk(df[2], df[3]); o.z = pk(df[4], df[5]); o.w = pk(df[6], df[7]);
            *(LAS u32x4*)(dt + i * DIFF_PITCH + lane * 16) = o;
            if (sp - (win - 1) >= 0) { float xo[8]; unpack8(*(const u32x4*)(base + (ptrdiff_t)(i - (win - 1)) * NPROJ), xo);
#pragma unroll
                for (int e = 0; e < 8; ++e) sum[e] -= xo[e]; }
        }
    }
    asm volatile("s_waitcnt lgkmcnt(0)" ::: "memory");
    __builtin_amdgcn_wave_barrier();
    const int fr = lane & 15, fq = lane >> 4;
    const size_t trow = (size_t)(t0 + fr);
#pragma unroll 1
    for (int g = 0; g < 4; ++g) {
        bf16x8 df[3];
#pragma unroll
        for (int ks = 0; ks < 3; ++ks) df[ks] = *(const LAS bf16x8*)(dt + fr * DIFF_PITCH + (g * PG + 32 * ks + 8 * fq) * 2);
#pragma unroll
        for (int nt = 0; nt < 6; ++nt) {
            f32x4 acc = (f32x4){0.f, 0.f, 0.f, 0.f};
            const bf16_t* wrow = PWT + (size_t)((g * PG + 16 * nt + fr) * PG + 8 * fq);
#pragma unroll
            for (int ks = 0; ks < 3; ++ks) { const bf16x8 wf = *(const bf16x8*)(wrow + 32 * ks); acc = __builtin_amdgcn_mfma_f32_16x16x32_bf16(wf, df[ks], acc, 0, 0, 0); }
            const int ch = g * PG + 16 * nt + 4 * fq;
            const f32x4 sc = *(const f32x4*)(a.pool_scale + ch);
            const u32x2 gp = *(const u32x2*)(P + trow * NPROJ + OFF_GP + ch);
            u32x2 o; o.x = pk(acc[0] * sc[0] * silu(bflo(gp.x)), acc[1] * sc[1] * silu(bfhi(gp.x))); o.y = pk(acc[2] * sc[2] * silu(bflo(gp.y)), acc[3] * sc[3] * silu(bfhi(gp.y)));
            *(u32x2*)(MIX + trow * D + DC + ch) = o;
        }
    }
}

__device__ __forceinline__ void mix_attn(const bf16_t* P, const bf16_t* KV, bf16_t* MIX, LAS unsigned char* lds, int tile0, int tid, int wave, int lane) {
    const int b = tile0 / SEQ, fr = lane & 15, fq = lane >> 4, t0 = tile0 + wave * 16;
    const size_t trow = (size_t)(t0 + fr);
    const bf16_t* kvb = KV + (size_t)b * NMEM * 512;
#pragma unroll 1
    for (int h = 0; h < NH; ++h) {
        __syncthreads();
#pragma unroll
        for (int k = 0; k < 4; ++k) { const int id = tid + NTHREADS * k, key = id >> 3, part = id & 7;
            const u32x4 v = *(const u32x4*)(kvb + (size_t)key * 512 + h * HD + part * 8);
            *(LAS u32x4*)(lds + KS_OFF + key * KS_PITCH + part * 16) = v; }
#pragma unroll
        for (int k = 0; k < 4; ++k) { const int id = tid + NTHREADS * k, key = id & 255, part = id >> 8;
            const u32x4 v = *(const u32x4*)(kvb + (size_t)key * 512 + 256 + h * HD + part * 8);
            LAS bf16_t* vt = (LAS bf16_t*)(lds + VT_OFF + (part * 8) * VT_PITCH + key * 2);
            vt[0 * (VT_PITCH / 2)] = (bf16_t)(v.x & 0xffffu); vt[1 * (VT_PITCH / 2)] = (bf16_t)(v.x >> 16);
            vt[2 * (VT_PITCH / 2)] = (bf16_t)(v.y & 0xffffu); vt[3 * (VT_PITCH / 2)] = (bf16_t)(v.y >> 16);
            vt[4 * (VT_PITCH / 2)] = (bf16_t)(v.z & 0xffffu); vt[5 * (VT_PITCH / 2)] = (bf16_t)(v.z >> 16);
            vt[6 * (VT_PITCH / 2)] = (bf16_t)(v.w & 0xffffu); vt[7 * (VT_PITCH / 2)] = (bf16_t)(v.w >> 16); }
        bf16x8 qf[2];
#pragma unroll
        for (int ks = 0; ks < 2; ++ks) qf[ks] = *(const bf16x8*)(P + trow * NPROJ + OFF_Q + h * HD + 32 * ks + 8 * fq);
        __syncthreads();
        f32x4 s[16];
#pragma unroll
        for (int j = 0; j < 16; ++j) { s[j] = (f32x4){0.f, 0.f, 0.f, 0.f};
#pragma unroll
            for (int ks = 0; ks < 2; ++ks) { const bf16x8 kf = *(const LAS bf16x8*)(lds + KS_OFF + (16 * j + fr) * KS_PITCH + (32 * ks + 8 * fq) * 2);
                s[j] = __builtin_amdgcn_mfma_f32_16x16x32_bf16(kf, qf[ks], s[j], 0, 0, 0); } }
        float mx = -3.0e38f;
#pragma unroll
        for (int j = 0; j < 16; ++j) mx = fmaxf(mx, fmaxf(fmaxf(s[j][0], s[j][1]), fmaxf(s[j][2], s[j][3])));
        mx = fmaxf(mx, __shfl_xor(mx, 16)); mx = fmaxf(mx, __shfl_xor(mx, 32));
        const float c2 = 0.125f * 1.44269504088896f; float l = 0.f;
        bf16x8 pf[8];
#pragma unroll
        for (int J = 0; J < 8; ++J) {
            float p[8];
#pragma unroll
            for (int i = 0; i < 4; ++i) { p[i] = __builtin_amdgcn_exp2f((s[2 * J][i] - mx) * c2); p[4 + i] = __builtin_amdgcn_exp2f((s[2 * J + 1][i] - mx) * c2); }
            l += ((p[0] + p[1]) + (p[2] + p[3])) + ((p[4] + p[5]) + (p[6] + p[7]));
            u32x4 w; w.x = pk(p[0], p[1]); w.y = pk(p[2], p[3]); w.z = pk(p[4], p[5]); w.w = pk(p[6], p[7]);
            pf[J] = __builtin_bit_cast(bf16x8, w);
        }
        l += __shfl_xor(l, 16); l += __shfl_xor(l, 32);
        const float rl = 1.0f / l;
#pragma unroll
        for (int nt = 0; nt < 4; ++nt) {
            f32x4 o = (f32x4){0.f, 0.f, 0.f, 0.f};
#pragma unroll
            for (int J = 0; J < 8; ++J) {
                const LAS unsigned char* vr = lds + VT_OFF + (16 * nt + fr) * VT_PITCH + (32 * J + 4 * fq) * 2;
                const u32x2 lo = *(const LAS u32x2*)vr, hi = *(const LAS u32x2*)(vr + 32);
                u32x4 w; w.x = lo.x; w.y = lo.y; w.z = hi.x; w.w = hi.y;
                o = __builtin_amdgcn_mfma_f32_16x16x32_bf16(__builtin_bit_cast(bf16x8, w), pf[J], o, 0, 0, 0);
            }
            const int ch = h * HD + 16 * nt + 4 * fq;
            const u32x2 ga = *(const u32x2*)(P + trow * NPROJ + OFF_GA + ch);
            u32x2 ov; ov.x = pk(o[0] * rl * silu(bflo(ga.x)), o[1] * rl * silu(bfhi(ga.x))); ov.y = pk(o[2] * rl * silu(bflo(ga.y)), o[3] * rl * silu(bfhi(ga.y)));
            *(u32x2*)(MIX + trow * D + DC + DP + ch) = ov;
        }
    }
}

__device__ __forceinline__ void p2_mix(const Args& a, LAS unsigned char* lds, int tid, int wave, int lane) {
    const bf16_t* P = (const bf16_t*)(a.ws + WS_P); const bf16_t* KV = (const bf16_t*)(a.ws + WS_KV); const bf16_t* PWT = (const bf16_t*)(a.ws + WS_PW); bf16_t* MIX = (bf16_t*)(a.ws + WS_MIX);
    for (int u = blockIdx.x; u < NTOK / 128; u += gridDim.x) {
        const int tile0 = u * 128;
        mix_conv(a, P, MIX, tile0, tid);
        __syncthreads();
        mix_pool(a, P, PWT, MIX, lds, tile0, wave, lane);
        mix_attn(P, KV, MIX, lds, tile0, tid, wave, lane);
    }
}

__device__ __forceinline__ void p4_final(const Args& a, int wave, int lane) {
    const int gw = blockIdx.x * NWAVES + wave, NGW = gridDim.x * NWAVES;
    const f32x4* wr = (const f32x4*)a.post_w + lane;
    for (int m = gw; m < NTOK; m += NGW) {
        f32x4* yr = (f32x4*)(a.out + (size_t)m * D) + lane; const f32x4* xr = (const f32x4*)(a.x + (size_t)m * D) + lane;
        f32x4 v[4], xv[4]; float s = 0.f;
#pragma unroll
        for (int j = 0; j < 4; ++j) { v[j] = yr[64 * j]; xv[j] = xr[64 * j]; s += (v[j].x * v[j].x + v[j].y * v[j].y) + (v[j].z * v[j].z + v[j].w * v[j].w); }
        const float rstd = rsqrtf(wave_sum(s) * (1.f / D) + EPS);
#pragma unroll
        for (int j = 0; j < 4; ++j) { const f32x4 wv = wr[64 * j]; yr[64 * j] = xv[j] + v[j] * rstd * wv; }
    }
}

template <int LO, int HI>
__global__ void __launch_bounds__(NTHREADS, 2) mk_fwd(Args a) {
    extern __shared__ __attribute__((aligned(16))) unsigned char lds_raw[];
    LAS unsigned char* lds = (LAS unsigned char*)lds_raw;
    const int tid = threadIdx.x, lane = tid & 63, wave = __builtin_amdgcn_readfirstlane(tid >> 6);
#define IN(k) (LO <= (k) && (k) < HI)
#define SEAM(k) do { if constexpr (IN(k) && IN((k) + 1)) { cg::this_grid().sync(); } } while (0)
    if constexpr (IN(0)) { p0_prologue(a, lds, wave, lane); SEAM(0); }
    if constexpr (IN(1)) {
        pg8::Gemm g{(const bf16_t*)(a.ws + WS_ACAT), (const bf16_t*)(a.ws + WS_WCAT), NTOK + MEMROWS, NPROJ + 512, D};
        pg8::Order1 S; S.init((int)gridDim.x, (int)blockIdx.x);
        pg8::EpiP1 E{(bf16_t*)(a.ws + WS_P), (bf16_t*)(a.ws + WS_KV)};
        pg8::gemm_phase<pg8::EpiP1, pg8::Order1, true>(lds, g, S, E);
        SEAM(1);
    }
    if constexpr (IN(2)) { p2_mix(a, lds, tid, wave, lane); SEAM(2); }
    if constexpr (IN(3)) {
        pg8::Gemm g{(const bf16_t*)(a.ws + WS_MIX), (const bf16_t*)(a.ws + WS_WOUT), NTOK, D, D};
        pg8::StaticOrder S; S.init(NTOK, D, (int)gridDim.x, (int)blockIdx.x);
        pg8::EpiF32 E{a.out, D};
        pg8::gemm_phase<pg8::EpiF32, pg8::StaticOrder, true>(lds, g, S, E);
        SEAM(3);
    }
    if constexpr (IN(4)) { p4_final(a, wave, lane); }
#undef IN
#undef SEAM
}

template <int LO, int HI> static void launch_range(const Args& a, int grid, bool coop, hipStream_t stream) {
    static bool attr = false;
    if (!attr) { (void)hipFuncSetAttribute((const void*)mk_fwd<LO, HI>, hipFuncAttributeMaxDynamicSharedMemorySize, LDS_BYTES); attr = true; }
    if (coop) {
        Args aa = a; void* args[] = {&aa};
        hipError_t e = hipLaunchCooperativeKernel((const void*)mk_fwd<LO, HI>, dim3(grid), dim3(NTHREADS), args, LDS_BYTES, stream);
        if (e != hipSuccess) fprintf(stderr, "cooperative launch failed: %s (grid %d)\n", hipGetErrorString(e), grid);
    } else {
        hipLaunchKernelGGL((mk_fwd<LO, HI>), dim3(grid), dim3(NTHREADS), LDS_BYTES, stream, a);
    }
}

extern "C" void kernel_launch(void* const* d_in, const int* in_sizes, int n_in, void* d_out, int out_size, void* d_ws, size_t ws_size, hipStream_t stream) {
    if (n_in != 11 || ws_size < WS_END || out_size != NTOK * D) { fprintf(stderr, "kernel_launch: unexpected n_in %d / ws %zu / out %d\n", n_in, ws_size, out_size); return; }
    static int grid = 0;
    if (grid == 0) {
        int dev = 0, cus = 0, per_cu = 0;
        (void)hipGetDevice(&dev); (void)hipDeviceGetAttribute(&cus, hipDeviceAttributeMultiprocessorCount, dev);
        (void)hipFuncSetAttribute((const void*)mk_fwd<0, 5>, hipFuncAttributeMaxDynamicSharedMemorySize, LDS_BYTES);
        (void)hipOccupancyMaxActiveBlocksPerMultiprocessor(&per_cu, (const void*)mk_fwd<0, 5>, NTHREADS, LDS_BYTES);
        if (per_cu < 1) { fprintf(stderr, "kernel_launch: occupancy query reports %d blocks per CU\n", per_cu); per_cu = 1; }
        if (per_cu > 1) per_cu = 1;
        grid = cus * per_cu;
    }
    Args a{};
    a.x = (const float*)d_in[0]; a.mem = (const float*)d_in[1]; a.pre_w = (const float*)d_in[2]; a.mem_w = (const float*)d_in[3]; a.w_in = (const float*)d_in[4];
    a.conv_w = (const float*)d_in[5]; a.pool_w = (const float*)d_in[6]; a.pool_scale = (const float*)d_in[7]; a.w_kv = (const float*)d_in[8]; a.w_out = (const float*)d_in[9];
    a.post_w = (const float*)d_in[10]; a.out = (float*)d_out; a.ws = (unsigned char*)d_ws;
#if MK_N_LAUNCHES == 1
    launch_range<0, 5>(a, grid, true, stream);
#else
    launch_range<0, 1>(a, grid, false, stream);
    launch_range<1, 2>(a, grid, false, stream);
    launch_range<2, 3>(a, grid, false, stream);
    launch_range<3, 4>(a, grid, false, stream);
    launch_range<4, 5>(a, grid, false, stream);
#endif
}
```
